# Optimizing an MI355X kernel written in HIP

```python
import jax, jax.numpy as jnp
from jax import lax
import numpy as np

D_MODEL = 1024
BATCH = 2
SEQ = 8192
DEPTH = 2

HEAD_DIM = 64
H_HGRN = 4
H_GLA = 6
H_RWKV = 6
W_HGRN = H_HGRN * HEAD_DIM
W_GLA = H_GLA * HEAD_DIM
W_RWKV = H_RWKV * HEAD_DIM
MIX_WIDTH = W_HGRN + W_GLA + W_RWKV

GLA_GATE_RANK = 16
GLA_GATE_NORMALIZER = 16.0
RWKV_DECAY_RANK = 64
RWKV_ICLR_RANK = 64
RWKV_GATE_RANK = 128
RWKV_GN_EPS = 64e-5

N_HGRN_COLS = 4 * W_HGRN
N_GLA_COLS = 4 * W_GLA + GLA_GATE_RANK
N_RWKV_COLS = 3 * W_RWKV + RWKV_DECAY_RANK + RWKV_ICLR_RANK + RWKV_GATE_RANK
N_IN = N_HGRN_COLS + N_GLA_COLS + N_RWKV_COLS
RWKV_SPLITS = [W_RWKV, 2 * W_RWKV, 3 * W_RWKV, 3 * W_RWKV + RWKV_DECAY_RANK,
               3 * W_RWKV + RWKV_DECAY_RANK + RWKV_ICLR_RANK]

D_FF = 4 * D_MODEL
CHUNK = 64
LN_EPS = 1e-5
RMS_EPS = 1e-5
F_MIN = 1e-30
DEEPNORM_ALPHA = (2.0 * DEPTH) ** 0.25
DEEPNORM_BETA = (8.0 * DEPTH) ** -0.25

kernel_name = "hybrid_hgrn2_gla_rwkv7_deepnorm_adaln"


def split_heads(t, n_heads):
    return t.reshape(t.shape[:-1] + (n_heads, -1))


def layer_norm(x, g, b):
    xf = x.astype(jnp.float32)
    mu = jnp.mean(xf, axis=-1, keepdims=True)
    var = jnp.mean(jnp.square(xf - mu), axis=-1, keepdims=True)
    return ((xf - mu) * lax.rsqrt(var + LN_EPS)).astype(x.dtype) * g + b


def head_rms_norm(x, g, n_heads):
    xh = split_heads(x, n_heads).astype(jnp.float32)
    xh = xh * lax.rsqrt(jnp.mean(xh * xh, axis=-1, keepdims=True) + RMS_EPS)
    return xh.reshape(x.shape).astype(x.dtype) * g


def head_group_norm(x, g, b, n_heads, eps):
    xh = split_heads(x, n_heads).astype(jnp.float32)
    mu = jnp.mean(xh, axis=-1, keepdims=True)
    var = jnp.mean(jnp.square(xh - mu), axis=-1, keepdims=True)
    return ((xh - mu) * lax.rsqrt(var + eps)).reshape(x.shape).astype(x.dtype) * g + b


def chunked_gated_linear_attention(q, k, v, log_g):
    B, T, H, K = q.shape
    V = v.shape[-1]
    n = T // CHUNK

    def to_chunks(a):
        return jnp.moveaxis(a.astype(jnp.float32).reshape(B, n, CHUNK, H, a.shape[-1]), 1, 0)

    causal = jnp.tril(jnp.ones((CHUNK, CHUNK), dtype=bool))[None, :, :, None, None]

    def step(S, inp):
        qc, kc, vc, gc = inp
        b = jnp.cumsum(gc, axis=1)
        diff = b[:, :, None] - b[:, None, :]
        decay = jnp.where(causal, jnp.exp(jnp.minimum(diff, 0.0)), 0.0)
        scores = jnp.einsum('bthk,bshk,btshk->bths', qc, kc, decay)
        o = (jnp.einsum('bths,bshv->bthv', scores, vc)
             + jnp.einsum('bthk,bhkv->bthv', qc * jnp.exp(b), S))
        b_end = b[:, -1]
        S = (S * jnp.exp(b_end)[..., None]
             + jnp.einsum('bshk,bshv->bhkv', kc * jnp.exp(b_end[:, None] - b), vc))
        return S, o

    S0 = jnp.zeros((B, H, K, V), jnp.float32)
    _, o = lax.scan(step, S0, (to_chunks(q), to_chunks(k), to_chunks(v), to_chunks(log_g)))
    return jnp.moveaxis(o, 0, 1).reshape(B, T, H, V)


def rwkv7_recurrence(r, w, k, v, a, b):
    B, T, H, D = r.shape

    def step(S, inp):
        r_t, w_t, k_t, v_t, a_t, b_t = inp
        sa = jnp.einsum('bhvk,bhk->bhv', S, a_t)
        S = S * w_t[:, :, None, :] + sa[..., None] * b_t[:, :, None, :] + v_t[..., None] * k_t[:, :, None, :]
        return S, jnp.einsum('bhvk,bhk->bhv', S, r_t)

    xs = tuple(jnp.moveaxis(t.astype(jnp.float32), 1, 0) for t in (r, w, k, v, a, b))
    S0 = jnp.zeros((B, H, D, D), jnp.float32)
    _, y = lax.scan(step, S0, xs)
    return jnp.moveaxis(y, 0, 1)


def hgrn2_mixer(z, lower_bound, norm_g):
    B, T, _ = z.shape
    q, f_logit, i, gate = jnp.split(z, 4, axis=-1)
    zf = f_logit.astype(jnp.float32)
    f = lower_bound + (1.0 - lower_bound) * jax.nn.sigmoid(zf)
    log_f = jnp.log(jnp.maximum(f, F_MIN))
    k = (1.0 - lower_bound) * jax.nn.sigmoid(-zf)
    q = jax.nn.silu(q.astype(jnp.float32)) * HEAD_DIM ** -0.5
    o = chunked_gated_linear_attention(split_heads(q, H_HGRN), split_heads(k, H_HGRN),
                                       split_heads(i, H_HGRN), split_heads(log_f, H_HGRN))
    o = o.reshape(B, T, W_HGRN).astype(z.dtype)
    return head_rms_norm(o, norm_g, H_HGRN) * jax.nn.silu(gate)


def gla_mixer(z, alpha_up, alpha_b, norm_g):
    B, T, _ = z.shape
    q, k, v, r, h_alpha = jnp.split(z, [W_GLA, 2 * W_GLA, 3 * W_GLA, 4 * W_GLA], axis=-1)
    log_alpha = jax.nn.log_sigmoid((h_alpha @ alpha_up + alpha_b).astype(jnp.float32)) / GLA_GATE_NORMALIZER
    o = chunked_gated_linear_attention(split_heads(q * HEAD_DIM ** -0.5, H_GLA), split_heads(k, H_GLA),
                                       split_heads(v, H_GLA), split_heads(log_alpha, H_GLA))
    o = o.reshape(B, T, W_GLA).astype(z.dtype)
    return head_rms_norm(o, norm_g, H_GLA) * jax.nn.silu(r)


def rwkv7_mixer(z, mu, w0, w_up, a0, a_up, g_up, k_k, k_a, r_k, gn_g, gn_b):
    B, T, _ = z.shape
    z_prev = jnp.pad(z, ((0, 0), (1, 0), (0, 0)))[:, :-1]
    z = z + (z_prev - z) * mu
    r, k, v, h_w, h_a, h_g = jnp.split(z, RWKV_SPLITS, axis=-1)
    w_log = -jax.nn.softplus(-(w0 + jnp.tanh(h_w) @ w_up)) - 0.5
    decay = jnp.exp(-jnp.exp(w_log.astype(jnp.float32)))
    a = jax.nn.sigmoid(a0 + h_a @ a_up)
    g = jax.nn.sigmoid(h_g) @ g_up
    kk = split_heads(k * k_k, H_RWKV).astype(jnp.float32)
    kk = kk / jnp.maximum(jnp.sqrt(jnp.sum(kk * kk, axis=-1, keepdims=True)), 1e-12)
    k = k * (1.0 + (a - 1.0) * k_a)
    a_h = split_heads(a, H_RWKV).astype(jnp.float32)
    r_h, k_h, v_h = split_heads(r, H_RWKV), split_heads(k, H_RWKV), split_heads(v, H_RWKV)
    y = rwkv7_recurrence(r_h, split_heads(decay, H_RWKV), k_h, v_h, -kk, kk * a_h)
    y = head_group_norm(y.reshape(B, T, W_RWKV).astype(z.dtype), gn_g, gn_b, H_RWKV, RWKV_GN_EPS)
    bonus = jnp.sum(r_h * k_h * r_k, axis=-1, keepdims=True) * v_h
    return (y + bonus.reshape(B, T, W_RWKV)) * g


def setup_inputs(seed: int = 0) -> dict:
    key = jax.random.key(seed)
    ks = iter(jax.random.split(key, 32))
    nrm = lambda shape, s: s * jax.random.normal(next(ks), shape, jnp.float32)
    L = DEPTH
    return {
        "x": nrm((BATCH, SEQ, D_MODEL), 1.0),
        "c": nrm((BATCH, D_MODEL), 1.0),
        "hgrn_lb_logits": nrm((L, W_HGRN), 1.0),
        "ada_w": nrm((L, D_MODEL, 6 * D_MODEL), 0.1 * D_MODEL ** -0.5),
        "ada_b": nrm((L, 6 * D_MODEL), 0.01),
        "w_in": nrm((L, D_MODEL, N_IN), D_MODEL ** -0.5),
        "hgrn_norm_g": 1.0 + nrm((L, W_HGRN), 0.02),
        "gla_alpha_up": nrm((L, GLA_GATE_RANK, W_GLA), GLA_GATE_RANK ** -0.5),
        "gla_alpha_b": nrm((L, W_GLA), 0.1),
        "gla_norm_g": 1.0 + nrm((L, W_GLA), 0.02),
        "rwkv_mu": jax.random.uniform(next(ks), (L, N_RWKV_COLS), jnp.float32, 0.0, 1.0),
        "rwkv_w0": jax.random.uniform(next(ks), (L, W_RWKV), jnp.float32, -6.0, 1.0),
        "rwkv_w_up": nrm((L, RWKV_DECAY_RANK, W_RWKV), 0.5 * RWKV_DECAY_RANK ** -0.5),
        "rwkv_a0": nrm((L, W_RWKV), 0.1),
        "rwkv_a_up": nrm((L, RWKV_ICLR_RANK, W_RWKV), RWKV_ICLR_RANK ** -0.5),
        "rwkv_g_up": nrm((L, RWKV_GATE_RANK, W_RWKV), RWKV_GATE_RANK ** -0.5),
        "rwkv_k_k": 0.85 + nrm((L, W_RWKV), 0.02),
        "rwkv_k_a": 1.0 + nrm((L, W_RWKV), 0.02),
        "rwkv_r_k": nrm((L, H_RWKV, HEAD_DIM), 0.1),
        "rwkv_gn_g": 1.0 + nrm((L, W_RWKV), 0.02),
        "rwkv_gn_b": nrm((L, W_RWKV), 0.02),
        "w_out": nrm((L, MIX_WIDTH, D_MODEL), DEEPNORM_BETA * MIX_WIDTH ** -0.5),
        "ln1_g": 1.0 + nrm((L, D_MODEL), 0.02),
        "ln1_b": nrm((L, D_MODEL), 0.02),
        "mlp_w_up": nrm((L, D_MODEL, D_FF), D_MODEL ** -0.5),
        "mlp_w_down": nrm((L, D_FF, D_MODEL), DEEPNORM_BETA * D_FF ** -0.5),
        "ln2_g": 1.0 + nrm((L, D_MODEL), 0.02),
        "ln2_b": nrm((L, D_MODEL), 0.02),
    }


def reference(x, c, hgrn_lb_logits, ada_w, ada_b, w_in, hgrn_norm_g, gla_alpha_up, gla_alpha_b,
              gla_norm_g, rwkv_mu, rwkv_w0, rwkv_w_up, rwkv_a0, rwkv_a_up, rwkv_g_up, rwkv_k_k,
              rwkv_k_a, rwkv_r_k, rwkv_gn_g, rwkv_gn_b, w_out, ln1_g, ln1_b, mlp_w_up, mlp_w_down,
              ln2_g, ln2_b):
    p = jax.nn.softmax(hgrn_lb_logits.astype(jnp.float32), axis=0)
    lower_bounds = jnp.cumsum(p, axis=0) - p[0:1]
    c_act = jax.nn.silu(c)
    for l in range(DEPTH):
        mod = c_act @ ada_w[l] + ada_b[l]
        shift1, scale1, gate1, shift2, scale2, gate2 = [m[:, None, :] for m in jnp.split(mod, 6, axis=-1)]

        h = x * (1.0 + scale1) + shift1
        z = h @ w_in[l]
        z_h, z_g, z_r = jnp.split(z, [N_HGRN_COLS, N_HGRN_COLS + N_GLA_COLS], axis=-1)
        o_h = hgrn2_mixer(z_h, lower_bounds[l], hgrn_norm_g[l])
        o_g = gla_mixer(z_g, gla_alpha_up[l], gla_alpha_b[l], gla_norm_g[l])
        o_r = rwkv7_mixer(z_r, rwkv_mu[l], rwkv_w0[l], rwkv_w_up[l], rwkv_a0[l], rwkv_a_up[l],
                          rwkv_g_up[l], rwkv_k_k[l], rwkv_k_a[l], rwkv_r_k[l], rwkv_gn_g[l], rwkv_gn_b[l])
        o = jnp.concatenate([o_h, o_g, o_r], axis=-1) @ w_out[l]
        x = layer_norm(DEEPNORM_ALPHA * x + (1.0 + gate1) * o, ln1_g[l], ln1_b[l])

        h = x * (1.0 + scale2) + shift2
        m = jnp.square(jax.nn.relu(h @ mlp_w_up[l])) @ mlp_w_down[l]
        x = layer_norm(DEEPNORM_ALPHA * x + (1.0 + gate2) * m, ln2_g[l], ln2_b[l])
    return x
```

```cpp
#include <hip/hip_runtime.h>
#include <cstdio>
#include <cstdint>

namespace nv {
constexpr int D = 1024, BATCH = 2, SEQ = 8192, DEPTH = 2;
constexpr int NIN = 3984, DFF = 4096;
constexpr float DN_ALPHA = 1.4142135623730951f;

__device__ __forceinline__ float wave_sum(float v) {
#pragma unroll
    for (int o = 1; o < 64; o <<= 1) v += __shfl_xor(v, o);
    return v;
}
__device__ __forceinline__ float sigmoidf_(float x) { return 1.f / (1.f + expf(-x)); }
__device__ __forceinline__ float softplusf_(float x) { return fmaxf(x, 0.f) + log1pf(expf(-fabsf(x))); }

__global__ void __launch_bounds__(256) k_mod(const float* __restrict__ c, const float* __restrict__ ada_w, const float* __restrict__ ada_b, float* __restrict__ mod) {
    const int n = blockIdx.x * 256 + threadIdx.x, b = blockIdx.y, l = blockIdx.z;
    float acc = ada_b[l * 6 * D + n];
    for (int k = 0; k < D; ++k) { float cv = c[b * D + k]; cv = cv * sigmoidf_(cv); acc += cv * ada_w[((size_t)l * D + k) * (6 * D) + n]; }
    mod[(size_t)(l * BATCH + b) * 6 * D + n] = acc;
}

template <int MODE>
__global__ void __launch_bounds__(256) k_gemm(const float* __restrict__ A, int lda, const float* __restrict__ B, int N, int K, float* __restrict__ C, int ldc,
                                              const float* __restrict__ scale, const float* __restrict__ shift, const float* __restrict__ res, const float* __restrict__ gate) {
    __shared__ float As[8][128 + 4];
    __shared__ float Bs[8][128 + 4];
    const int tid = threadIdx.x, ty = tid >> 4, tx = tid & 15;
    const int m0 = blockIdx.y * 128, n0 = blockIdx.x * 128;
    float acc[8][8];
#pragma unroll
    for (int i = 0; i < 8; ++i)
#pragma unroll
        for (int j = 0; j < 8; ++j) acc[i][j] = 0.f;
    const int ar = tid >> 1, akq = (tid & 1) * 4;
    const int bk = tid >> 5, bn = (tid & 31) * 4;
    for (int k0 = 0; k0 < K; k0 += 8) {
        float4 av = *(const float4*)(A + (size_t)(m0 + ar) * lda + k0 + akq);
        if (MODE == 0 || MODE == 2) {
            const float4 sc = *(const float4*)(scale + k0 + akq), sh = *(const float4*)(shift + k0 + akq);
            av.x = av.x * (1.f + sc.x) + sh.x; av.y = av.y * (1.f + sc.y) + sh.y; av.z = av.z * (1.f + sc.z) + sh.z; av.w = av.w * (1.f + sc.w) + sh.w;
        }
        float4 bv = make_float4(0.f, 0.f, 0.f, 0.f);
        if (n0 + bn < N) bv = *(const float4*)(B + (size_t)(k0 + bk) * N + n0 + bn);
        __syncthreads();
        As[akq + 0][ar] = av.x; As[akq + 1][ar] = av.y; As[akq + 2][ar] = av.z; As[akq + 3][ar] = av.w;
        *(float4*)&Bs[bk][bn] = bv;
        __syncthreads();
#pragma unroll
        for (int k = 0; k < 8; ++k) {
            float a[8], b[8];
            *(float4*)&a[0] = *(const float4*)&As[k][ty * 8]; *(float4*)&a[4] = *(const float4*)&As[k][ty * 8 + 4];
            *(float4*)&b[0] = *(const float4*)&Bs[k][tx * 8]; *(float4*)&b[4] = *(const float4*)&Bs[k][tx * 8 + 4];
#pragma unroll
            for (int i = 0; i < 8; ++i)
#pragma unroll
                for (int j = 0; j < 8; ++j) acc[i][j] += a[i] * b[j];
        }
    }
#pragma unroll
    for (int i = 0; i < 8; ++i) {
        const int m = m0 + ty * 8 + i;
#pragma unroll
        for (int j = 0; j < 8; ++j) {
            const int n = n0 + tx * 8 + j;
            if (n < N) {
                float v = acc[i][j];
                if (MODE == 1) v = DN_ALPHA * res[(size_t)m * ldc + n] + (1.f + gate[n]) * v;
                if (MODE == 2) { v = fmaxf(v, 0.f); v = v * v; }
                C[(size_t)m * ldc + n] = v;
            }
        }
    }
}

__global__ void __launch_bounds__(256) k_ln(const float* __restrict__ Y, const float* __restrict__ g, const float* __restrict__ bta, float* __restrict__ out) {
    const int row = blockIdx.x * 4 + (threadIdx.x >> 6), lane = threadIdx.x & 63;
    const float* y = Y + (size_t)row * D;
    float v[16]; float s = 0.f;
#pragma unroll
    for (int i = 0; i < 16; ++i) { v[i] = y[lane + 64 * i]; s += v[i]; }
    const float mean = wave_sum(s) * (1.f / D); float q = 0.f;
#pragma unroll
    for (int i = 0; i < 16; ++i) { v[i] -= mean; q += v[i] * v[i]; }
    const float rstd = rsqrtf(wave_sum(q) * (1.f / D) + 1e-5f);
#pragma unroll
    for (int i = 0; i < 16; ++i) out[(size_t)row * D + lane + 64 * i] = v[i] * rstd * g[lane + 64 * i] + bta[lane + 64 * i];
}

struct MixP {
    const float* Z; float* O; int l;
    const float *lb_logits, *hgrn_norm_g, *alpha_up, *alpha_b, *gla_norm_g;
    const float *mu, *w0, *w_up, *a0, *a_up, *g_up, *k_k, *k_a, *r_k, *gn_g, *gn_b;
};

__global__ void __launch_bounds__(64) k_mix(MixP p) {
    __shared__ float s0[64], s1[64], s2[64], s3[64], s4[64], sl[256];
    const int lane = threadIdx.x, l = p.l;
    float S[64];
#pragma unroll
    for (int i = 0; i < 64; ++i) S[i] = 0.f;
    if (blockIdx.x < 4) {
        const int h = blockIdx.x, ch = h * 64 + lane;
        const float l0 = p.lb_logits[ch], l1 = p.lb_logits[256 + ch], mx = fmaxf(l0, l1), e0 = expf(l0 - mx), e1 = expf(l1 - mx);
        const float lb = (l == 0) ? 0.f : e1 / (e0 + e1);
        const float ng = p.hgrn_norm_g[l * 256 + ch];
        for (int t = 0; t < SEQ; ++t) {
            const float* z = p.Z + (size_t)t * NIN;
            const float qr = z[ch], zf = z[256 + ch], vi = z[512 + ch], gt = z[768 + ch];
            const float f = lb + (1.f - lb) * sigmoidf_(zf);
            s0[lane] = qr * sigmoidf_(qr) * 0.125f; s1[lane] = (1.f - lb) * sigmoidf_(-zf); s2[lane] = fmaxf(f, 1e-30f);
            __syncthreads();
            float o = 0.f;
#pragma unroll
            for (int i = 0; i < 64; ++i) { S[i] = S[i] * s2[i] + s1[i] * vi; o += S[i] * s0[i]; }
            __syncthreads();
            const float rn = rsqrtf(wave_sum(o * o) * (1.f / 64.f) + 1e-5f);
            p.O[(size_t)t * D + ch] = o * rn * ng * (gt * sigmoidf_(gt));
        }
    } else if (blockIdx.x < 10) {
        const int h = blockIdx.x - 4, ch = h * 64 + lane;
        float au[16];
#pragma unroll
        for (int m = 0; m < 16; ++m) au[m] = p.alpha_up[((size_t)l * 16 + m) * 384 + ch];
        const float ab = p.alpha_b[l * 384 + ch], ng = p.gla_norm_g[l * 384 + ch];
        for (int t = 0; t < SEQ; ++t) {
            const float* z = p.Z + (size_t)t * NIN + 1024;
            const float q = z[ch] * 0.125f, k = z[384 + ch], v = z[768 + ch], r = z[1152 + ch];
            float x = ab;
#pragma unroll
            for (int m = 0; m < 16; ++m) x += z[1536 + m] * au[m];
            const float lg = -softplusf_(-x) * (1.f / 16.f);
            s0[lane] = q; s1[lane] = k; s2[lane] = expf(lg);
            __syncthreads();
            float o = 0.f;
#pragma unroll
            for (int i = 0; i < 64; ++i) { S[i] = S[i] * s2[i] + s1[i] * v; o += S[i] * s0[i]; }
            __syncthreads();
            const float rn = rsqrtf(wave_sum(o * o) * (1.f / 64.f) + 1e-5f);
            p.O[(size_t)t * D + 256 + ch] = o * rn * ng * (r * sigmoidf_(r));
        }
    } else {
        const int h = blockIdx.x - 10, ch = h * 64 + lane;
        const float* mu = p.mu + (size_t)l * 1408;
        const float w0 = p.w0[l * 384 + ch], a0 = p.a0[l * 384 + ch], kk_ = p.k_k[l * 384 + ch], ka_ = p.k_a[l * 384 + ch];
        const float rk_ = p.r_k[(l * 6 + h) * 64 + lane], gg = p.gn_g[l * 384 + ch], gb = p.gn_b[l * 384 + ch];
        const float* wup = p.w_up + (size_t)l * 64 * 384 + ch;
        const float* aup = p.a_up + (size_t)l * 64 * 384 + ch;
        const float* gup = p.g_up + (size_t)l * 128 * 384 + ch;
        for (int t = 0; t < SEQ; ++t) {
            asm volatile("" ::: "memory");
            const float* zr = p.Z + (size_t)t * NIN + 2576;
            const float* zp = zr - NIN;
#define SHF(col) ({ const float zc_ = zr[(col)]; const float zq_ = (t > 0) ? zp[(col)] : 0.f; zc_ + (zq_ - zc_) * mu[(col)]; })
            const float r = SHF(ch), k = SHF(384 + ch), v = SHF(768 + ch);
            sl[lane] = tanhf(SHF(1152 + lane)); sl[64 + lane] = SHF(1216 + lane);
            sl[128 + lane] = sigmoidf_(SHF(1280 + lane)); sl[192 + lane] = sigmoidf_(SHF(1344 + lane));
#undef SHF
            __syncthreads();
            float wl = w0, al = a0, g = 0.f;
#pragma unroll 4
            for (int m = 0; m < 64; ++m) { wl += sl[m] * wup[m * 384]; al += sl[64 + m] * aup[m * 384]; }
#pragma unroll 4
            for (int m = 0; m < 128; ++m) g += sl[128 + m] * gup[m * 384];
            const float wlog = -softplusf_(-wl) - 0.5f, decay = expf(-expf(wlog)), a = sigmoidf_(al);
            float kkv = k * kk_; const float nrm = sqrtf(wave_sum(kkv * kkv)); kkv = kkv / fmaxf(nrm, 1e-12f);
            const float k2 = k * (1.f + (a - 1.f) * ka_);
            s0[lane] = r; s1[lane] = decay; s2[lane] = k2; s3[lane] = -kkv; s4[lane] = kkv * a;
            __syncthreads();
            float sa = 0.f;
#pragma unroll
            for (int i = 0; i < 64; ++i) sa += S[i] * s3[i];
            float y = 0.f;
#pragma unroll
            for (int i = 0; i < 64; ++i) { S[i] = S[i] * s1[i] + sa * s4[i] + v * s2[i]; y += S[i] * s0[i]; }
            __syncthreads();
            const float mean = wave_sum(y) * (1.f / 64.f), dy = y - mean, var = wave_sum(dy * dy) * (1.f / 64.f);
            const float yn = dy * rsqrtf(var + 64e-5f) * gg + gb;
            const float bonus = wave_sum(r * k2 * rk_) * v;
            p.O[(size_t)t * D + 640 + ch] = (yn + bonus) * g;
        }
    }
}
}

extern "C" void kernel_launch(void* const* d_in, const int* in_sizes, int n_in, void* d_out, int out_size, void* d_ws, size_t ws_size, hipStream_t stream) {
    using namespace nv;
    const float* x = (const float*)d_in[0]; const float* c = (const float*)d_in[1];
    const float* ada_w = (const float*)d_in[3]; const float* ada_b = (const float*)d_in[4]; const float* w_in = (const float*)d_in[5];
    const float* w_out = (const float*)d_in[21]; const float* ln1_g = (const float*)d_in[22]; const float* ln1_b = (const float*)d_in[23];
    const float* w_up = (const float*)d_in[24]; const float* w_dn = (const float*)d_in[25]; const float* ln2_g = (const float*)d_in[26]; const float* ln2_b = (const float*)d_in[27];
    float* out = (float*)d_out; char* ws = (char*)d_ws;
    const size_t MiB = 1u << 20;
    float* Z = (float*)(ws); float* HB = Z; float* O = (float*)(ws + 128 * MiB); float* Y = (float*)(ws + 160 * MiB); float* X1 = (float*)(ws + 192 * MiB); float* mod = (float*)(ws + 224 * MiB);
    k_mod<<<dim3(24, BATCH, DEPTH), 256, 0, stream>>>(c, ada_w, ada_b, mod);
    for (int l = 0; l < DEPTH; ++l)
        for (int b = 0; b < BATCH; ++b) {
            const float* xin = (l == 0 ? x : (const float*)out) + (size_t)b * SEQ * D;
            const float* mp = mod + (size_t)(l * BATCH + b) * 6 * D;
            k_gemm<0><<<dim3(32, 64), 256, 0, stream>>>(xin, D, w_in + (size_t)l * D * NIN, NIN, D, Z, NIN, mp + 1024, mp, nullptr, nullptr);
            MixP p{};
            p.Z = Z; p.O = O; p.l = l;
            p.lb_logits = (const float*)d_in[2]; p.hgrn_norm_g = (const float*)d_in[6]; p.alpha_up = (const float*)d_in[7]; p.alpha_b = (const float*)d_in[8]; p.gla_norm_g = (const float*)d_in[9];
            p.mu = (const float*)d_in[10]; p.w0 = (const float*)d_in[11]; p.w_up = (const float*)d_in[12]; p.a0 = (const float*)d_in[13]; p.a_up = (const float*)d_in[14]; p.g_up = (const float*)d_in[15];
            p.k_k = (const float*)d_in[16]; p.k_a = (const float*)d_in[17]; p.r_k = (const float*)d_in[18]; p.gn_g = (const float*)d_in[19]; p.gn_b = (const float*)d_in[20];
            k_mix<<<16, 64, 0, stream>>>(p);
            k_gemm<1><<<dim3(8, 64), 256, 0, stream>>>(O, D, w_out + (size_t)l * D * D, D, D, Y, D, nullptr, nullptr, xin, mp + 2048);
            k_ln<<<SEQ / 4, 256, 0, stream>>>(Y, ln1_g + l * D, ln1_b + l * D, X1);
            k_gemm<2><<<dim3(32, 64), 256, 0, stream>>>(X1, D, w_up + (size_t)l * D * DFF, DFF, D, HB, DFF, mp + 4096, mp + 3072, nullptr, nullptr);
            k_gemm<1><<<dim3(8, 64), 256, 0, stream>>>(HB, DFF, w_dn + (size_t)l * DFF * D, D, DFF, Y, D, nullptr, nullptr, X1, mp + 5120);
            k_ln<<<SEQ / 4, 256, 0, stream>>>(Y, ln2_g + l * D, ln2_b + l * D, out + (size_t)b * SEQ * D);
        }
}
```
